# Optimizing an MI355X kernel written in HIP

```python
import math
import jax, jax.numpy as jnp
from jax import lax
import numpy as np

D_MODEL = 1024
BATCH = 8
SEQ = 2048
DEPTH = 1

DA_HEADS = 8
DA_HEAD_DIM = 64
DA_V_DIM = 2 * DA_HEAD_DIM
DA_QK_WIDTH = DA_HEADS * 2 * DA_HEAD_DIM
DA_WIDTH = DA_HEADS * DA_V_DIM
SUBLN_EPS = 1e-5
DL_HEADS = 16
DL_HEAD_DIM = 64
DL_WIDTH = DL_HEADS * DL_HEAD_DIM
DL_DILATIONS = (1, 4, 16)
DL_OFFSETS = 128
BLOCK = 128
REL_BUCKETS = 32
REL_MAX_DISTANCE = 2048
N_REL_HEADS = DA_HEADS + DL_HEADS
DEEPNORM_ALPHA = (2.0 * DEPTH) ** 0.25
DEEPNORM_BETA = (8.0 * DEPTH) ** -0.25
LN_EPS = 1e-5
IN_SPLIT_SIZES = (DA_QK_WIDTH, DA_QK_WIDTH, DA_WIDTH, DA_WIDTH, DL_WIDTH, DL_WIDTH, DL_WIDTH, DL_WIDTH, D_MODEL, D_MODEL)
IN_COL_SCALES = (1.0, 1.0, DEEPNORM_BETA, 1.0, 1.0, 1.0, DEEPNORM_BETA, 1.0, 1.0, 1.0)
N_IN = sum(IN_SPLIT_SIZES)

kernel_name = "hybrid_diffattn_dilated_gated_merge"


def rel_bucket(dist):
    dist = jnp.maximum(dist, 0).astype(jnp.int32)
    max_exact = REL_BUCKETS // 2
    distf = jnp.maximum(dist, 1).astype(jnp.float32)
    large = max_exact + (jnp.log(distf / max_exact) / math.log(REL_MAX_DISTANCE / max_exact)
                         * (REL_BUCKETS - max_exact)).astype(jnp.int32)
    large = jnp.minimum(large, REL_BUCKETS - 1)
    return jnp.where(dist < max_exact, dist, large)


def layer_norm(x, g, b):
    xf = x.astype(jnp.float32)
    mu = jnp.mean(xf, -1, keepdims=True)
    var = jnp.mean(jnp.square(xf - mu), -1, keepdims=True)
    return ((xf - mu) * lax.rsqrt(var + LN_EPS) * g + b).astype(x.dtype)


def diff_attention(q, k, v, table_a, lam, subln_w, lam_init):
    B_, S_ = q.shape[:2]
    nb = S_ // BLOCK
    scale = DA_HEAD_DIM ** -0.5
    qb = jnp.moveaxis(q.reshape(B_, nb, BLOCK, DA_HEADS, 2, DA_HEAD_DIM), 1, 0)
    kpos = jnp.arange(S_)
    vf = v.astype(jnp.float32)

    def one_block(args):
        qblk, bi = args
        qpos = bi * BLOCK + jnp.arange(BLOCK)
        rel = qpos[:, None] - kpos[None, :]
        bias = table_a[rel_bucket(rel)].transpose(2, 0, 1)
        s = jnp.einsum('bqhmd,bkhmd->bhmqk', qblk, k).astype(jnp.float32) * scale + bias[:, None]
        s = jnp.where(rel[None, None, None] >= 0, s, -jnp.inf)
        p = jax.nn.softmax(s, axis=-1)
        a = p[:, :, 0] - lam * p[:, :, 1]
        return jnp.einsum('bhqk,bkhe->bqhe', a, vf)

    o = lax.map(one_block, (qb, jnp.arange(nb)))
    o = jnp.moveaxis(o, 0, 1).reshape(B_, S_, DA_HEADS, DA_V_DIM)
    o = o * lax.rsqrt(jnp.mean(jnp.square(o), -1, keepdims=True) + SUBLN_EPS) * subln_w
    o = o * (1.0 - lam_init)
    return o.reshape(B_, S_, DA_WIDTH).astype(q.dtype)


def dilated_pattern(q, k, v, table_b, dilation):
    B_, S_, H, dh = q.shape
    L = S_ // dilation
    nb = -(-L // BLOCK)
    Lp = nb * BLOCK
    scale = DL_HEAD_DIM ** -0.5

    def to_sub(t):
        t = t.reshape(B_, L, dilation, H, dh).transpose(0, 2, 3, 1, 4)
        t = jnp.pad(t, ((0, 0), (0, 0), (0, 0), (0, Lp - L), (0, 0)))
        return t.reshape(B_, dilation, H, nb, BLOCK, dh)

    def with_prev(t):
        prev = jnp.pad(t, ((0, 0), (0, 0), (0, 0), (1, 0), (0, 0), (0, 0)))[:, :, :, :-1]
        return jnp.concatenate([prev, t], axis=4)

    qs = to_sub(q)
    kw = with_prev(to_sub(k))
    vw = with_prev(to_sub(v)).astype(jnp.float32)
    i = jnp.arange(BLOCK)[:, None]
    j = jnp.arange(2 * BLOCK)[None, :]
    delta = i - j + BLOCK
    band = (delta >= 0) & (delta <= DL_OFFSETS)
    first = (jnp.arange(nb)[:, None, None] > 0) | (j[None] >= BLOCK)
    mask = band[None] & first
    bias = table_b[rel_bucket(delta * dilation)].transpose(2, 0, 1)
    s = jnp.einsum('brhnqd,brhnkd->brhnqk', qs, kw).astype(jnp.float32) * scale + bias[:, None]
    s = jnp.where(mask, s, -jnp.inf)
    m = jnp.max(s, axis=-1)
    e = jnp.exp(s - m[..., None])
    den = jnp.sum(e, axis=-1)
    o = jnp.einsum('brhnqk,brhnkd->brhnqd', e, vw) / den[..., None]

    def from_sub(t):
        t = t.reshape((B_, dilation, H, Lp) + t.shape[5:])[:, :, :, :L]
        t = jnp.moveaxis(t, 3, 1)
        return t.reshape((B_, S_, H) + t.shape[4:])

    return from_sub(o), from_sub(m), from_sub(den)


def dilated_attention(q, k, v, table_b):
    outs = [dilated_pattern(q, k, v, table_b, d) for d in DL_DILATIONS]
    ms = jnp.stack([r[1] for r in outs])
    dens = jnp.stack([r[2] for r in outs])
    os_ = jnp.stack([r[0] for r in outs])
    w = dens * jnp.exp(ms - jnp.max(ms, axis=0, keepdims=True))
    o = jnp.sum(w[..., None] * os_, axis=0) / jnp.sum(w, axis=0)[..., None]
    B_, S_ = q.shape[:2]
    return o.reshape(B_, S_, DL_WIDTH).astype(q.dtype)


def setup_inputs(seed: int = 0) -> dict:
    key = jax.random.key(seed)
    ks = jax.random.split(key, 16)
    f32 = jnp.float32
    x = jax.random.normal(ks[0], (BATCH, SEQ, D_MODEL), f32)
    col_scale = jnp.concatenate([jnp.full((n,), s, f32) for n, s in zip(IN_SPLIT_SIZES, IN_COL_SCALES)])
    w_in = jax.random.normal(ks[1], (DEPTH, D_MODEL, N_IN), f32) * (D_MODEL ** -0.5) * col_scale
    b_gate = 0.1 * jax.random.normal(ks[2], (DEPTH, 2, D_MODEL), f32)
    w_proj_a = jax.random.normal(ks[3], (DEPTH, DA_WIDTH, D_MODEL), f32) * (DA_WIDTH ** -0.5) * DEEPNORM_BETA
    w_proj_b = jax.random.normal(ks[4], (DEPTH, DL_WIDTH, D_MODEL), f32) * (DL_WIDTH ** -0.5) * DEEPNORM_BETA
    w_out = jax.random.normal(ks[5], (DEPTH, D_MODEL, D_MODEL), f32) * (D_MODEL ** -0.5) * DEEPNORM_BETA
    da_lambda_q1 = 0.1 * jax.random.normal(ks[6], (DEPTH, DA_HEAD_DIM), f32)
    da_lambda_k1 = 0.1 * jax.random.normal(ks[7], (DEPTH, DA_HEAD_DIM), f32)
    da_lambda_q2 = 0.1 * jax.random.normal(ks[8], (DEPTH, DA_HEAD_DIM), f32)
    da_lambda_k2 = 0.1 * jax.random.normal(ks[9], (DEPTH, DA_HEAD_DIM), f32)
    da_subln_w = 1.0 + 0.02 * jax.random.normal(ks[10], (DEPTH, DA_V_DIM), f32)
    rel_bias = 0.2 * jax.random.normal(ks[11], (REL_BUCKETS, N_REL_HEADS), f32)
    ln_g = 1.0 + 0.02 * jax.random.normal(ks[12], (DEPTH, D_MODEL), f32)
    ln_b = 0.02 * jax.random.normal(ks[13], (DEPTH, D_MODEL), f32)
    return {"x": x, "w_in": w_in, "b_gate": b_gate, "w_proj_a": w_proj_a, "w_proj_b": w_proj_b,
            "w_out": w_out, "da_lambda_q1": da_lambda_q1, "da_lambda_k1": da_lambda_k1,
            "da_lambda_q2": da_lambda_q2, "da_lambda_k2": da_lambda_k2, "da_subln_w": da_subln_w,
            "rel_bias": rel_bias, "ln_g": ln_g, "ln_b": ln_b}


def reference(x, w_in, b_gate, w_proj_a, w_proj_b, w_out, da_lambda_q1, da_lambda_k1,
              da_lambda_q2, da_lambda_k2, da_subln_w, rel_bias, ln_g, ln_b):
    B_, S_, _ = x.shape
    split_idx = tuple(int(c) for c in np.cumsum(IN_SPLIT_SIZES)[:-1])
    table_a = rel_bias[:, :DA_HEADS]
    table_b = rel_bias[:, DA_HEADS:]
    for layer in range(DEPTH):
        h = jnp.einsum('bsd,dn->bsn', x, w_in[layer])
        aq, ak, av, az, bq, bk, bv, bz, ga, gb = jnp.split(h, split_idx, axis=-1)
        lam_init = 0.8 - 0.6 * math.exp(-0.3 * layer)
        lam = (jnp.exp(jnp.sum(da_lambda_q1[layer].astype(jnp.float32) * da_lambda_k1[layer]))
               - jnp.exp(jnp.sum(da_lambda_q2[layer].astype(jnp.float32) * da_lambda_k2[layer])) + lam_init)
        ya = diff_attention(aq.reshape(B_, S_, DA_HEADS, 2, DA_HEAD_DIM),
                            ak.reshape(B_, S_, DA_HEADS, 2, DA_HEAD_DIM),
                            av.reshape(B_, S_, DA_HEADS, DA_V_DIM),
                            table_a, lam, da_subln_w[layer].astype(jnp.float32), lam_init)
        yb = dilated_attention(bq.reshape(B_, S_, DL_HEADS, DL_HEAD_DIM),
                               bk.reshape(B_, S_, DL_HEADS, DL_HEAD_DIM),
                               bv.reshape(B_, S_, DL_HEADS, DL_HEAD_DIM), table_b)
        ua = jnp.einsum('bse,ed->bsd', ya * jax.nn.silu(az), w_proj_a[layer])
        ub = jnp.einsum('bse,ed->bsd', yb * jax.nn.silu(bz), w_proj_b[layer])
        merged = jax.nn.sigmoid(ga + b_gate[layer, 0]) * ua + jax.nn.sigmoid(gb + b_gate[layer, 1]) * ub
        sub = jnp.einsum('bsd,de->bse', merged, w_out[layer])
        x = layer_norm(DEEPNORM_ALPHA * x + sub, ln_g[layer], ln_b[layer])
    return x
```

```cpp
#include <hip/hip_runtime.h>
#include <cstdint>
#include <cstdio>

namespace slow {
constexpr int S = 2048, DM = 1024, NB = 8, NIN = 10240;
constexpr int HA = 8, HB = 16;

__device__ __forceinline__ int rel_bucket(int d) {
    if (d < 16) return d < 0 ? 0 : d;
    int b = 16;
    b += (d >= 22); b += (d >= 30); b += (d >= 40); b += (d >= 54); b += (d >= 73); b += (d >= 99); b += (d >= 134); b += (d >= 182);
    b += (d >= 246); b += (d >= 332); b += (d >= 450); b += (d >= 609); b += (d >= 825); b += (d >= 1117); b += (d >= 1513);
    return b;
}

__global__ void __launch_bounds__(256) sgemm_nn(const float* __restrict__ A, int lda, const float* __restrict__ B, int ldb, float* __restrict__ C, int ldc, int M, int N, int K) {
    __shared__ float As[16][65];
    __shared__ float Bs[16][65];
    const int tid = threadIdx.x, tx = tid & 15, ty = tid >> 4;
    const int m0 = blockIdx.y * 64, n0 = blockIdx.x * 64;
    float acc[4][4] = {};
    for (int k0 = 0; k0 < K; k0 += 16) {
        for (int i = tid; i < 64 * 16; i += 256) { const int r = i >> 4, c = i & 15; As[c][r] = A[(size_t)(m0 + r) * lda + k0 + c]; }
        for (int i = tid; i < 16 * 64; i += 256) { const int r = i >> 6, c = i & 63; Bs[r][c] = B[(size_t)(k0 + r) * ldb + n0 + c]; }
        __syncthreads();
#pragma unroll
        for (int k = 0; k < 16; ++k) {
            float a[4], b[4];
#pragma unroll
            for (int i = 0; i < 4; ++i) { a[i] = As[k][ty * 4 + i]; b[i] = Bs[k][tx * 4 + i]; }
#pragma unroll
            for (int i = 0; i < 4; ++i)
#pragma unroll
                for (int j = 0; j < 4; ++j) acc[i][j] += a[i] * b[j];
        }
        __syncthreads();
    }
#pragma unroll
    for (int i = 0; i < 4; ++i)
#pragma unroll
        for (int j = 0; j < 4; ++j) C[(size_t)(m0 + ty * 4 + i) * ldc + n0 + tx * 4 + j] = acc[i][j];
}

__device__ __forceinline__ float block_sum(float v, float* red) {
    for (int o = 32; o > 0; o >>= 1) v += __shfl_xor(v, o);
    const int w = threadIdx.x >> 6;
    __syncthreads();
    if ((threadIdx.x & 63) == 0) red[w] = v;
    __syncthreads();
    float s = 0.f;
    for (int i = 0; i < (int)(blockDim.x >> 6); ++i) s += red[i];
    return s;
}
__device__ __forceinline__ float block_max(float v, float* red) {
    for (int o = 32; o > 0; o >>= 1) v = fmaxf(v, __shfl_xor(v, o));
    const int w = threadIdx.x >> 6;
    __syncthreads();
    if ((threadIdx.x & 63) == 0) red[w] = v;
    __syncthreads();
    float s = -INFINITY;
    for (int i = 0; i < (int)(blockDim.x >> 6); ++i) s = fmaxf(s, red[i]);
    return s;
}

__global__ void __launch_bounds__(256) diff_attn(const float* __restrict__ hb, const float* __restrict__ rel_bias, const float* lq1, const float* lk1, const float* lq2, const float* lk2,
                                                   const float* __restrict__ subln_w, float* __restrict__ ya  ) {
    __shared__ float sc[2][S];
    __shared__ float qs[128];
    __shared__ float red[8];
    __shared__ float outv[128];
    const int i = blockIdx.x, h = blockIdx.y, tid = threadIdx.x;
    if (tid < 128) qs[tid] = hb[(size_t)i * NIN + 0 + h * 128 + tid];
    __syncthreads();
    float lam;
    {
        float a = 0.f, b = 0.f;
        for (int d = 0; d < 64; ++d) { a += lq1[d] * lk1[d]; b += lq2[d] * lk2[d]; }
        lam = expf(a) - expf(b) + 0.2f;
    }
    const float scale = 0.125f;
    float mx0 = -INFINITY, mx1 = -INFINITY;
    for (int j = tid; j <= i; j += 256) {
        const float* kr = hb + (size_t)j * NIN + 1024 + h * 128;
        float s0 = 0.f, s1 = 0.f;
        for (int d = 0; d < 64; ++d) { s0 += qs[d] * kr[d]; s1 += qs[64 + d] * kr[64 + d]; }
        const float bias = rel_bias[rel_bucket(i - j) * 24 + h];
        s0 = s0 * scale + bias; s1 = s1 * scale + bias;
        sc[0][j] = s0; sc[1][j] = s1; mx0 = fmaxf(mx0, s0); mx1 = fmaxf(mx1, s1);
    }
    mx0 = block_max(mx0, red); mx1 = block_max(mx1, red);
    float l0 = 0.f, l1 = 0.f;
    for (int j = tid; j <= i; j += 256) { const float e0 = expf(sc[0][j] - mx0), e1 = expf(sc[1][j] - mx1); sc[0][j] = e0; sc[1][j] = e1; l0 += e0; l1 += e1; }
    l0 = block_sum(l0, red); l1 = block_sum(l1, red);
    __syncthreads();
    const float i0 = 1.f / l0, i1 = lam / l1;
    {
        const int e = tid & 127, half = tid >> 7;
        float acc = 0.f;
        for (int j = half; j <= i; j += 2) { const float a = sc[0][j] * i0 - sc[1][j] * i1; acc += a * hb[(size_t)j * NIN + 2048 + h * 128 + e]; }
        if (half == 1) outv[e] = acc;
        __syncthreads();
        if (half == 0) outv[e] += acc;
        __syncthreads();
    }
    float sq = (tid < 128) ? outv[tid] * outv[tid] : 0.f;
    sq = block_sum(sq, red);
    const float r = rsqrtf(sq / 128.f + 1e-5f);
    if (tid < 128) ya[(size_t)i * 1024 + h * 128 + tid] = outv[tid] * r * subln_w[tid] * 0.8f;
}

__global__ void __launch_bounds__(128) dilated_attn(const float* __restrict__ hb, const float* __restrict__ rel_bias, float* __restrict__ yb  ) {
    __shared__ float sc[3][129];
    __shared__ float qs[64];
    __shared__ float red[8];
    const int t = blockIdx.x, h = blockIdx.y, tid = threadIdx.x;
    if (tid < 64) qs[tid] = hb[(size_t)t * NIN + 4096 + h * 64 + tid];
    __syncthreads();
    float mx = -INFINITY;
    for (int p = 0; p < 3; ++p) {
        const int D = 1 << (2 * p), r = t % D, l = t / D;
        for (int dl = tid; dl <= 128; dl += 128) {
            const int lp = l - dl;
            float s = -INFINITY;
            if (lp >= 0) {
                const float* kr = hb + (size_t)(lp * D + r) * NIN + 5120 + h * 64;
                float a = 0.f;
                for (int d = 0; d < 64; ++d) a += qs[d] * kr[d];
                s = a * 0.125f + rel_bias[rel_bucket(dl * D) * 24 + 8 + h];
            }
            sc[p][dl] = s; mx = fmaxf(mx, s);
        }
    }
    mx = block_max(mx, red);
    float lsum = 0.f;
    for (int idx = tid; idx < 3 * 129; idx += 128) { const int p = idx / 129, dl = idx % 129; const float e = (sc[p][dl] == -INFINITY) ? 0.f : expf(sc[p][dl] - mx); sc[p][dl] = e; lsum += e; }
    lsum = block_sum(lsum, red);
    __syncthreads();
    const int d = tid & 63, half = tid >> 6;
    float acc = 0.f;
    for (int p = 0; p < 3; ++p) {
        const int D = 1 << (2 * p), r = t % D, l = t / D;
        for (int dl = half; dl <= 128; dl += 2) { const int lp = l - dl; if (lp >= 0) acc += sc[p][dl] * hb[(size_t)(lp * D + r) * NIN + 6144 + h * 64 + d]; }
    }
    __shared__ float o2[64];
    if (half == 1) o2[d] = acc;
    __syncthreads();
    if (half == 0) yb[(size_t)t * 1024 + h * 64 + d] = (acc + o2[d]) / lsum;
}

__device__ __forceinline__ float silu(float z) { return z / (1.f + expf(-z)); }
__device__ __forceinline__ float sigm(float z) { return 1.f / (1.f + expf(-z)); }

__global__ void gate_mul(const float* __restrict__ hb, float* ya, float* yb) {
    const size_t idx = (size_t)blockIdx.x * 256 + threadIdx.x;
    const int row = (int)(idx >> 10), c = (int)(idx & 1023);
    ya[idx] *= silu(hb[(size_t)row * NIN + 3072 + c]);
    yb[idx] *= silu(hb[(size_t)row * NIN + 7168 + c]);
}
__global__ void merge_k(const float* __restrict__ hb, const float* __restrict__ b_gate, const float* ua, const float* ub, float* merged) {
    const size_t idx = (size_t)blockIdx.x * 256 + threadIdx.x;
    const int row = (int)(idx >> 10), c = (int)(idx & 1023);
    merged[idx] = sigm(hb[(size_t)row * NIN + 8192 + c] + b_gate[c]) * ua[idx] + sigm(hb[(size_t)row * NIN + 9216 + c] + b_gate[1024 + c]) * ub[idx];
}
__global__ void __launch_bounds__(256) ln_out(const float* __restrict__ x, const float* __restrict__ sub, const float* __restrict__ g, const float* __restrict__ b, float* __restrict__ out) {
    __shared__ float red[8];
    const int row = blockIdx.x, tid = threadIdx.x;
    const float alpha = 1.189207115002721f;
    float v[4]; float s = 0.f;
    for (int j = 0; j < 4; ++j) { const int c = tid + 256 * j; v[j] = alpha * x[(size_t)row * 1024 + c] + sub[(size_t)row * 1024 + c]; s += v[j]; }
    const float mean = block_sum(s, red) / 1024.f;
    float q = 0.f;
    for (int j = 0; j < 4; ++j) { const float d = v[j] - mean; q += d * d; }
    const float var = block_sum(q, red) / 1024.f;
    const float rstd = rsqrtf(var + 1e-5f);
    for (int j = 0; j < 4; ++j) { const int c = tid + 256 * j; out[(size_t)row * 1024 + c] = (v[j] - mean) * rstd * g[c] + b[c]; }
}
}

extern "C" void kernel_launch(void* const* d_in, const int* in_sizes, int n_in, void* d_out, int out_size, void* d_ws, size_t ws_size, hipStream_t stream) {
    using namespace slow;
    const float* x = (const float*)d_in[0]; const float* w_in = (const float*)d_in[1]; const float* b_gate = (const float*)d_in[2];
    const float* wpa = (const float*)d_in[3]; const float* wpb = (const float*)d_in[4]; const float* wout = (const float*)d_in[5];
    const float* lq1 = (const float*)d_in[6]; const float* lk1 = (const float*)d_in[7]; const float* lq2 = (const float*)d_in[8]; const float* lk2 = (const float*)d_in[9];
    const float* subln = (const float*)d_in[10]; const float* relb = (const float*)d_in[11]; const float* ln_g = (const float*)d_in[12]; const float* ln_b = (const float*)d_in[13];
    float* out = (float*)d_out;
    float* ws = (float*)d_ws;
    float* hb = ws;
    float* ya = hb + (size_t)S * NIN;
    float* yb = ya + (size_t)S * 1024;
    float* ua = yb + (size_t)S * 1024;
    float* ub = ua + (size_t)S * 1024;
    float* mg = ub + (size_t)S * 1024;
    float* sub = mg + (size_t)S * 1024;
    for (int b = 0; b < NB; ++b) {
        const float* xb = x + (size_t)b * S * DM;
        sgemm_nn<<<dim3(NIN / 64, S / 64), 256, 0, stream>>>(xb, DM, w_in, NIN, hb, NIN, S, NIN, DM);
        diff_attn<<<dim3(S, HA), 256, 0, stream>>>(hb, relb, lq1, lk1, lq2, lk2, subln, ya);
        dilated_attn<<<dim3(S, HB), 128, 0, stream>>>(hb, relb, yb);
        gate_mul<<<S * 1024 / 256, 256, 0, stream>>>(hb, ya, yb);
        sgemm_nn<<<dim3(1024 / 64, S / 64), 256, 0, stream>>>(ya, 1024, wpa, 1024, ua, 1024, S, 1024, 1024);
        sgemm_nn<<<dim3(1024 / 64, S / 64), 256, 0, stream>>>(yb, 1024, wpb, 1024, ub, 1024, S, 1024, 1024);
        merge_k<<<S * 1024 / 256, 256, 0, stream>>>(hb, b_gate, ua, ub, mg);
        sgemm_nn<<<dim3(1024 / 64, S / 64), 256, 0, stream>>>(mg, 1024, wout, 1024, sub, 1024, S, 1024, 1024);
        ln_out<<<S, 256, 0, stream>>>(xb, sub, ln_g, ln_b, out + (size_t)b * S * DM);
    }
}
```
